# Optimizing an MI355X kernel written in HIP

```python
import math
import jax, jax.numpy as jnp
from jax import lax
import numpy as np

D_MODEL = 1024
BATCH = 8
SEQ = 2048
DEPTH = 2

N_A_LAYERS = DEPTH // 2
N_B_LAYERS = DEPTH - N_A_LAYERS
D_FF = 2816
MACARON_WEIGHT = 0.5
D_RNN = D_MODEL
LRU_HEADS = 4
LRU_BLOCK = D_RNN // LRU_HEADS
CONV_WIDTH = 4
LRU_C = 8.0
N_HEADS = 8
HEAD_DIM = D_MODEL // N_HEADS
MOBA_BLOCK = 256
MOBA_TOPK = 3
Q_CHUNK = 16
N_BUCKETS = 32
MAX_DISTANCE = 128
RMS_EPS = 1e-6

kernel_name = "yoco_rglru_moba_macaron"


def rms_norm(x, g):
    xf = x.astype(jnp.float32)
    y = xf * lax.rsqrt(jnp.mean(xf * xf, axis=-1, keepdims=True) + RMS_EPS)
    return (y * g.astype(jnp.float32)).astype(x.dtype)


def swiglu(x, w_gate, w_up, w_down):
    return (jax.nn.silu(x @ w_gate) * (x @ w_up)) @ w_down


def macaron_ffn(x, pre_g, post_g, w_gate, w_up, w_down):
    h = swiglu(rms_norm(x, pre_g), w_gate, w_up, w_down)
    return x + MACARON_WEIGHT * rms_norm(h, post_g)


def causal_dwconv(x, w, b):
    c = x.shape[-1]
    out = lax.conv_general_dilated(
        x, w[:, None, :].astype(x.dtype), window_strides=(1,),
        padding=[(CONV_WIDTH - 1, 0)], dimension_numbers=('NWC', 'WIO', 'NWC'),
        feature_group_count=c)
    return out + b


def rg_lru(x, w_r, b_r, w_i, b_i, lam):
    bn, s, c = x.shape
    xh = x.reshape(bn, s, LRU_HEADS, LRU_BLOCK)
    r = jax.nn.sigmoid(jnp.einsum('bshi,hij->bshj', xh, w_r).reshape(bn, s, c) + b_r)
    i = jax.nn.sigmoid(jnp.einsum('bshi,hij->bshj', xh, w_i).reshape(bn, s, c) + b_i)
    log_a = -LRU_C * r.astype(jnp.float32) * jax.nn.softplus(-lam.astype(jnp.float32))
    a = jnp.exp(log_a)
    mult = jnp.sqrt(-jnp.expm1(2.0 * log_a))
    u = mult * (i * x).astype(jnp.float32)

    def combine(left, right):
        a_l, b_l = left
        a_r, b_r2 = right
        return a_l * a_r, a_r * b_l + b_r2

    _, h = lax.associative_scan(combine, (a, u), axis=1)
    return h.astype(x.dtype)


def recurrent_block(xn, w_in, b_in, conv_w, conv_b, w_r, b_r, w_i, b_i, lam, w_out, b_out):
    proj = xn @ w_in + b_in
    xb, yb = jnp.split(proj, 2, axis=-1)
    xb = causal_dwconv(xb, conv_w, conv_b)
    h = rg_lru(xb, w_r, b_r, w_i, b_i, lam)
    return (h * jax.nn.gelu(yb)) @ w_out + b_out


def t5_bucket(dist):
    n = jnp.maximum(dist, 0)
    max_exact = N_BUCKETS // 2
    nf = jnp.maximum(n, 1).astype(jnp.float32)
    large = max_exact + (jnp.log(nf / max_exact) / math.log(MAX_DISTANCE / max_exact)
                         * (N_BUCKETS - max_exact)).astype(jnp.int32)
    large = jnp.minimum(large, N_BUCKETS - 1)
    return jnp.where(n < max_exact, n, large)


def shared_kv(x, kv_norm_g, w_kv):
    bn, s, _ = x.shape
    nblk = -(-s // MOBA_BLOCK)
    kv = rms_norm(x, kv_norm_g) @ w_kv
    k, v = jnp.split(kv, 2, axis=-1)
    pad = nblk * MOBA_BLOCK - s
    k = jnp.pad(k, ((0, 0), (0, pad), (0, 0)))
    v = jnp.pad(v, ((0, 0), (0, pad), (0, 0)))
    k_blk = k.reshape(bn, nblk, MOBA_BLOCK, N_HEADS, HEAD_DIM).transpose(0, 3, 1, 2, 4)
    v_blk = v.reshape(bn, nblk, MOBA_BLOCK, N_HEADS, HEAD_DIM).transpose(0, 3, 1, 2, 4)
    k_mean = jnp.mean(k_blk, axis=3)
    return k_blk, v_blk, k_mean


def moba_attention(q, k_blk, v_blk, k_mean, rel_bias):
    bn, s = q.shape[0], q.shape[1]
    nblk = k_blk.shape[2]
    topk = min(MOBA_TOPK, max(nblk - 1, 1))
    pos = jnp.arange(s)
    cur = pos // MOBA_BLOCK
    gate = jnp.einsum('bshd,bhnd->bhsn', q, k_mean).astype(jnp.float32)
    past = jnp.arange(nblk)[None, :] < cur[:, None]
    gate = jnp.where(past, gate, -jnp.inf)
    _, idx = lax.top_k(gate, topk)
    valid = idx < cur[None, None, :, None]

    nc = s // Q_CHUNK
    q_c = q.transpose(0, 2, 1, 3).reshape(bn, N_HEADS, nc, Q_CHUNK, HEAD_DIM).transpose(2, 0, 1, 3, 4)
    idx_c = idx.reshape(bn, N_HEADS, nc, Q_CHUNK, topk).transpose(2, 0, 1, 3, 4)
    valid_c = valid.reshape(bn, N_HEADS, nc, Q_CHUNK, topk).transpose(2, 0, 1, 3, 4)
    starts = jnp.arange(nc) * Q_CHUNK
    b_ix = jnp.arange(bn)[:, None, None, None]
    h_ix = jnp.arange(N_HEADS)[None, :, None, None]
    offs = jnp.arange(MOBA_BLOCK)
    scale = HEAD_DIM ** -0.5
    n_sel = topk * MOBA_BLOCK

    def chunk(args):
        qc, ic, vc, start = args
        t = start + jnp.arange(Q_CHUNK)
        ks = k_blk[b_ix, h_ix, ic]
        vs = v_blk[b_ix, h_ix, ic]
        kpos = ic[..., None] * MOBA_BLOCK + offs
        bias_s = rel_bias[h_ix[..., None], t5_bucket(t[:, None, None] - kpos)]
        s_sel = jnp.einsum('bhqd,bhqkjd->bhqkj', qc, ks).astype(jnp.float32) * scale + bias_s
        s_sel = jnp.where(vc[..., None], s_sel, -jnp.inf)
        cb = start // MOBA_BLOCK
        k_own = lax.dynamic_index_in_dim(k_blk, cb, axis=2, keepdims=False)
        v_own = lax.dynamic_index_in_dim(v_blk, cb, axis=2, keepdims=False)
        d_own = t[:, None] - (cb * MOBA_BLOCK + offs)[None, :]
        bias_o = rel_bias[:, t5_bucket(d_own)]
        s_own = jnp.einsum('bhqd,bhjd->bhqj', qc, k_own).astype(jnp.float32) * scale + bias_o
        s_own = jnp.where(d_own >= 0, s_own, -jnp.inf)
        logits = jnp.concatenate([s_sel.reshape(bn, N_HEADS, Q_CHUNK, n_sel), s_own], axis=-1)
        p = jax.nn.softmax(logits, axis=-1)
        p_sel = p[..., :n_sel].reshape(bn, N_HEADS, Q_CHUNK, topk, MOBA_BLOCK).astype(vs.dtype)
        p_own = p[..., n_sel:].astype(v_own.dtype)
        return (jnp.einsum('bhqkj,bhqkjd->bhqd', p_sel, vs)
                + jnp.einsum('bhqj,bhjd->bhqd', p_own, v_own))

    out = lax.map(chunk, (q_c, idx_c, valid_c, starts))
    return out.transpose(1, 0, 3, 2, 4).reshape(bn, s, N_HEADS * HEAD_DIM)


def setup_inputs(seed: int = 0) -> dict:
    key = jax.random.key(seed)
    ks = iter(jax.random.split(key, 64))

    def nrm(shape, scale):
        return jax.random.normal(next(ks), shape, jnp.float32) * scale

    def gain(shape):
        return 1.0 + nrm(shape, 0.05)

    d, f = D_MODEL, D_FF
    u = jax.random.uniform(next(ks), (N_A_LAYERS, D_RNN), jnp.float32, 0.9, 0.999)
    return {
        "x": nrm((BATCH, SEQ, d), 1.0),
        "ffn1_pre_g": gain((DEPTH, d)),
        "ffn1_post_g": gain((DEPTH, d)),
        "ffn1_w_gate": nrm((DEPTH, d, f), d ** -0.5),
        "ffn1_w_up": nrm((DEPTH, d, f), d ** -0.5),
        "ffn1_w_down": nrm((DEPTH, f, d), f ** -0.5),
        "ffn2_pre_g": gain((DEPTH, d)),
        "ffn2_post_g": gain((DEPTH, d)),
        "ffn2_w_gate": nrm((DEPTH, d, f), d ** -0.5),
        "ffn2_w_up": nrm((DEPTH, d, f), d ** -0.5),
        "ffn2_w_down": nrm((DEPTH, f, d), f ** -0.5),
        "mix_pre_g": gain((DEPTH, d)),
        "mix_post_g": gain((DEPTH, d)),
        "lru_w_in": nrm((N_A_LAYERS, d, 2 * D_RNN), d ** -0.5),
        "lru_b_in": nrm((N_A_LAYERS, 2 * D_RNN), 0.02),
        "lru_conv_w": nrm((N_A_LAYERS, CONV_WIDTH, D_RNN), CONV_WIDTH ** -0.5),
        "lru_conv_b": nrm((N_A_LAYERS, D_RNN), 0.02),
        "lru_w_r": nrm((N_A_LAYERS, LRU_HEADS, LRU_BLOCK, LRU_BLOCK), LRU_BLOCK ** -0.5),
        "lru_b_r": nrm((N_A_LAYERS, D_RNN), 0.02),
        "lru_w_i": nrm((N_A_LAYERS, LRU_HEADS, LRU_BLOCK, LRU_BLOCK), LRU_BLOCK ** -0.5),
        "lru_b_i": nrm((N_A_LAYERS, D_RNN), 0.02),
        "lru_lambda": jnp.log(u / (1.0 - u)),
        "lru_w_out": nrm((N_A_LAYERS, D_RNN, d), D_RNN ** -0.5),
        "lru_b_out": nrm((N_A_LAYERS, d), 0.02),
        "kv_norm_g": gain((d,)),
        "w_kv": nrm((d, 2 * N_HEADS * HEAD_DIM), d ** -0.5),
        "attn_w_q": nrm((N_B_LAYERS, d, N_HEADS * HEAD_DIM), d ** -0.5),
        "attn_w_o": nrm((N_B_LAYERS, N_HEADS * HEAD_DIM, d), (N_HEADS * HEAD_DIM) ** -0.5),
        "rel_bias": nrm((N_HEADS, N_BUCKETS), 0.5),
    }


def reference(x, ffn1_pre_g, ffn1_post_g, ffn1_w_gate, ffn1_w_up, ffn1_w_down,
              ffn2_pre_g, ffn2_post_g, ffn2_w_gate, ffn2_w_up, ffn2_w_down,
              mix_pre_g, mix_post_g,
              lru_w_in, lru_b_in, lru_conv_w, lru_conv_b, lru_w_r, lru_b_r, lru_w_i, lru_b_i,
              lru_lambda, lru_w_out, lru_b_out,
              kv_norm_g, w_kv, attn_w_q, attn_w_o, rel_bias):
    bn, s, _ = x.shape
    k_blk = v_blk = k_mean = None
    for l in range(DEPTH):
        x = macaron_ffn(x, ffn1_pre_g[l], ffn1_post_g[l], ffn1_w_gate[l], ffn1_w_up[l], ffn1_w_down[l])
        xn = rms_norm(x, mix_pre_g[l])
        if l < N_A_LAYERS:
            m = recurrent_block(xn, lru_w_in[l], lru_b_in[l], lru_conv_w[l], lru_conv_b[l],
                                lru_w_r[l], lru_b_r[l], lru_w_i[l], lru_b_i[l], lru_lambda[l],
                                lru_w_out[l], lru_b_out[l])
        else:
            j = l - N_A_LAYERS
            q = (xn @ attn_w_q[j]).reshape(bn, s, N_HEADS, HEAD_DIM)
            m = moba_attention(q, k_blk, v_blk, k_mean, rel_bias) @ attn_w_o[j]
        x = x + rms_norm(m, mix_post_g[l])
        x = macaron_ffn(x, ffn2_pre_g[l], ffn2_post_g[l], ffn2_w_gate[l], ffn2_w_up[l], ffn2_w_down[l])
        if l == N_A_LAYERS - 1:
            k_blk, v_blk, k_mean = shared_kv(x, kv_norm_g, w_kv)
    return x
```

```cpp
#include <hip/hip_runtime.h>
#include <hip/hip_fp16.h>
#include <stdint.h>
#include <cstdio>

typedef unsigned short bf16_t;

constexpr int BATCH = 8, SEQ = 2048, D = 1024, FF = 2816, NH = 8, HD = 128, BLK = 256, NBLK = SEQ / BLK;
constexpr int M = BATCH * SEQ;
constexpr float EPS = 1e-6f;
constexpr float LOG2E = 1.4426950408889634f;
constexpr float QSCALE = 0.08838834764831845f * LOG2E;

constexpr size_t MiB = 1u << 20;
constexpr size_t WS_CTL = 0;
constexpr size_t WS_RSS = 1 * MiB;
constexpr size_t WS_KMS = 1 * MiB + 256 * 1024;
constexpr size_t WS_BT  = 1 * MiB + 512 * 1024;
constexpr size_t WS_XCH = 2 * MiB;
constexpr size_t WS_W   = 4 * MiB;
constexpr size_t WS_XB  = 48 * MiB;
constexpr size_t WS_BIG = 80 * MiB;
constexpr size_t WS_H   = WS_BIG;
constexpr size_t WS_PY  = WS_BIG;
constexpr size_t WS_XC  = WS_BIG + 32 * MiB;
constexpr size_t WS_HG  = WS_XC;
constexpr size_t WS_PX  = WS_BIG + 64 * MiB;
constexpr size_t WS_AU  = WS_BIG + 64 * MiB;
constexpr size_t WS_QB  = WS_BIG;
constexpr size_t WS_AO  = WS_BIG + 32 * MiB;
constexpr size_t WS_KB  = WS_BIG + 88 * MiB;
constexpr size_t WS_VT  = WS_BIG + 120 * MiB;
constexpr size_t WS_END = WS_BIG + 152 * MiB;

__host__ __device__ __forceinline__ float bf2f(bf16_t v) { union { unsigned u; float f; } c; c.u = ((unsigned)v) << 16; return c.f; }
__host__ __device__ __forceinline__ bf16_t f2bf(float f) { union { unsigned u; float f; } c; c.f = f; return (bf16_t)((c.u + 0x7fffu + ((c.u >> 16) & 1u)) >> 16); }
__device__ __forceinline__ float wave_sum(float v) {
#pragma unroll
    for (int o = 32; o; o >>= 1) v += __shfl_xor(v, o);
    return v;
}
__device__ __forceinline__ float rstd_of(const float* RSS, int row) {
    const float4 s = *(const float4*)(RSS + (size_t)row * 4);
    return rsqrtf(((s.x + s.y) + (s.z + s.w)) * (1.0f / D) + EPS);
}
__device__ __forceinline__ float sigmoidf_(float x) { return 1.0f / (1.0f + __expf(-x)); }
__device__ __forceinline__ float gelu_tanh(float x) {
    const float u = 0.7978845608028654f * (x + 0.044715f * x * x * x);
    return 0.5f * x * (1.0f + tanhf(u));
}

__global__ void __launch_bounds__(256) nv_prep(const float* __restrict__ x, bf16_t* __restrict__ XB, float* __restrict__ RSS) {
    const int row = blockIdx.x * 4 + (threadIdx.x >> 6), lane = threadIdx.x & 63;
    const float4* xr = (const float4*)(x + (size_t)row * D);
#pragma unroll
    for (int j = 0; j < 4; ++j) {
        const float4 v = xr[64 * j + lane];
        float s = v.x * v.x + v.y * v.y + v.z * v.z + v.w * v.w;
        s = wave_sum(s);
        if (lane == 0) RSS[row * 4 + j] = s;
        ushort4 o; o.x = f2bf(v.x); o.y = f2bf(v.y); o.z = f2bf(v.z); o.w = f2bf(v.w);
        *(ushort4*)(XB + (size_t)row * D + 256 * j + 4 * lane) = o;
    }
}

__global__ void __launch_bounds__(256) nv_bias_table(const float* __restrict__ rel_bias, float* __restrict__ BT) {
    const int i = blockIdx.x * 256 + threadIdx.x;
    if (i >= NH * 129) return;
    const int h = i / 129, dist = i % 129;
    int bucket;
    if (dist < 16) bucket = dist;
    else { const float nf = (float)dist; int large = 16 + (int)(logf(nf / 16.0f) / logf(128.0f / 16.0f) * 16.0f); bucket = large < 31 ? large : 31; }
    if (dist >= 128) bucket = 31;
    BT[i] = rel_bias[h * 32 + bucket] * LOG2E;
}

template <class Epi>
__global__ void __launch_bounds__(256) nv_gemm(const bf16_t* __restrict__ A, int lda, long zA, const float* __restrict__ W1, const float* __restrict__ W2, int ldw, long zW,
                                               const float* __restrict__ ks, int K, Epi epi) {
    __shared__ float As[16][68];
    __shared__ float B1[16][64];
    __shared__ float B2[16][64];
    const int tx = threadIdx.x & 15, ty = threadIdx.x >> 4, z = blockIdx.z;
    const int row0 = blockIdx.y * 64, col0 = blockIdx.x * 64;
    A += (size_t)z * zA; W1 += (size_t)z * zW; if (W2) W2 += (size_t)z * zW;
    float c1[4][4], c2[4][4];
#pragma unroll
    for (int i = 0; i < 4; ++i)
#pragma unroll
        for (int j = 0; j < 4; ++j) { c1[i][j] = 0.f; c2[i][j] = 0.f; }
    for (int k0 = 0; k0 < K; k0 += 16) {
        { const int r = threadIdx.x >> 2, kk = (threadIdx.x & 3) * 4;
          const ushort4 a = *(const ushort4*)(A + (size_t)(row0 + r) * lda + k0 + kk);
          As[kk + 0][r] = bf2f(a.x); As[kk + 1][r] = bf2f(a.y); As[kk + 2][r] = bf2f(a.z); As[kk + 3][r] = bf2f(a.w); }
        { const int kk = threadIdx.x >> 4, cc = (threadIdx.x & 15) * 4; const float s = ks ? ks[k0 + kk] : 1.0f;
          const float4 w = *(const float4*)(W1 + (size_t)(k0 + kk) * ldw + col0 + cc);
          B1[kk][cc + 0] = w.x * s; B1[kk][cc + 1] = w.y * s; B1[kk][cc + 2] = w.z * s; B1[kk][cc + 3] = w.w * s;
          if (W2) { const float4 w2 = *(const float4*)(W2 + (size_t)(k0 + kk) * ldw + col0 + cc);
              B2[kk][cc + 0] = w2.x * s; B2[kk][cc + 1] = w2.y * s; B2[kk][cc + 2] = w2.z * s; B2[kk][cc + 3] = w2.w * s; } }
        __syncthreads();
#pragma unroll
        for (int kk = 0; kk < 16; ++kk) {
            float a[4], b1[4], b2[4];
#pragma unroll
            for (int i = 0; i < 4; ++i) { a[i] = As[kk][ty * 4 + i]; b1[i] = B1[kk][tx * 4 + i]; b2[i] = W2 ? B2[kk][tx * 4 + i] : 0.f; }
#pragma unroll
            for (int i = 0; i < 4; ++i)
#pragma unroll
                for (int j = 0; j < 4; ++j) { c1[i][j] += a[i] * b1[j]; c2[i][j] += a[i] * b2[j]; }
        }
        __syncthreads();
    }
#pragma unroll
    for (int i = 0; i < 4; ++i)
#pragma unroll
        for (int j = 0; j < 4; ++j) epi(row0 + ty * 4 + i, col0 + tx * 4 + j, z, c1[i][j], c2[i][j]);
}

struct EpSwiglu { const float* RSS; bf16_t* H;
    __device__ void operator()(int row, int col, int, float g, float u) const { const float r = rstd_of(RSS, row); g *= r; u *= r; H[(size_t)row * FF + col] = f2bf(g * sigmoidf_(g) * u); } };
struct EpInproj { const float* RSS; const float* b_in; bf16_t* PX; bf16_t* PY;
    __device__ void operator()(int row, int col, int, float v, float) const { v = v * rstd_of(RSS, row) + b_in[col];
        if (col < D) PX[(size_t)row * D + col] = f2bf(v); else PY[(size_t)row * D + col - D] = f2bf(v); } };
struct EpGates { const float* b_r; const float* b_i; const float* lam; const bf16_t* XC; __half2* AU;
    __device__ void operator()(int row, int col, int z, float vr, float vi) const { const int c = z * 256 + col;
        const float r = sigmoidf_(vr + b_r[c]), ig = sigmoidf_(vi + b_i[c]);
        const float sp = log1pf(__expf(-lam[c]));
        const float log_a = -8.0f * r * sp, a = __expf(log_a), mult = sqrtf(-expm1f(2.0f * log_a));
        const float u = mult * ig * bf2f(XC[(size_t)row * D + c]);
        AU[(size_t)row * D + c] = __floats2half2_rn(a, u); } };
struct EpKV { const float* RSS; bf16_t* KB; bf16_t* VT;
    __device__ void operator()(int row, int col, int, float v, float) const { v *= rstd_of(RSS, row);
        if (col < D) KB[(size_t)row * D + col] = f2bf(v); else VT[(size_t)(col - D) * M + row] = f2bf(v); } };
struct EpQ { const float* RSS; bf16_t* QB;
    __device__ void operator()(int row, int col, int, float v, float) const { QB[(size_t)row * D + col] = f2bf(v * rstd_of(RSS, row) * QSCALE); } };

__global__ void __launch_bounds__(256) nv_rowgemm_norm(const bf16_t* __restrict__ A, int K, const float* __restrict__ W, const float* __restrict__ bias, const float* __restrict__ gpost, float wres,
                                                       const float* xsrc, float* xdst, bf16_t* __restrict__ XB, float* __restrict__ RSS) {
    __shared__ bf16_t As[8 * FF];
    __shared__ float red[8][4];
    const int t = threadIdx.x, row0 = blockIdx.x * 8, wave = t >> 6, lane = t & 63;
    for (int i = t; i < 8 * K / 8; i += 256) { const int r = i / (K / 8), kk = (i % (K / 8)) * 8; *(uint4*)(As + r * K + kk) = *(const uint4*)(A + (size_t)(row0 + r) * K + kk); }
    __syncthreads();
    float acc[8][4];
#pragma unroll
    for (int r = 0; r < 8; ++r)
#pragma unroll
        for (int j = 0; j < 4; ++j) acc[r][j] = 0.f;
    for (int k = 0; k < K; ++k) {
        const float4 w = *(const float4*)(W + (size_t)k * D + 4 * t);
#pragma unroll
        for (int r = 0; r < 8; ++r) { const float a = bf2f(As[r * K + k]); acc[r][0] += a * w.x; acc[r][1] += a * w.y; acc[r][2] += a * w.z; acc[r][3] += a * w.w; }
    }
    const float4 bv = bias ? *(const float4*)(bias + 4 * t) : make_float4(0.f, 0.f, 0.f, 0.f);
    const float4 gp = *(const float4*)(gpost + 4 * t);
#pragma unroll
    for (int r = 0; r < 8; ++r) { acc[r][0] += bv.x; acc[r][1] += bv.y; acc[r][2] += bv.z; acc[r][3] += bv.w;
        float s = acc[r][0] * acc[r][0] + acc[r][1] * acc[r][1] + acc[r][2] * acc[r][2] + acc[r][3] * acc[r][3];
        s = wave_sum(s); if (lane == 0) red[r][wave] = s; }
    __syncthreads();
#pragma unroll
    for (int r = 0; r < 8; ++r) {
        const float tot = (red[r][0] + red[r][1]) + (red[r][2] + red[r][3]);
        const float rs = rsqrtf(tot * (1.0f / D) + EPS) * wres;
        const size_t off = (size_t)(row0 + r) * D + 4 * t;
        const float4 xs = *(const float4*)(xsrc + off);
        float4 xn; xn.x = xs.x + acc[r][0] * rs * gp.x; xn.y = xs.y + acc[r][1] * rs * gp.y; xn.z = xs.z + acc[r][2] * rs * gp.z; xn.w = xs.w + acc[r][3] * rs * gp.w;
        *(float4*)(xdst + off) = xn;
        ushort4 o; o.x = f2bf(xn.x); o.y = f2bf(xn.y); o.z = f2bf(xn.z); o.w = f2bf(xn.w);
        *(ushort4*)(XB + off) = o;
        float s = xn.x * xn.x + xn.y * xn.y + xn.z * xn.z + xn.w * xn.w;
        s = wave_sum(s); if (lane == 0) RSS[(size_t)(row0 + r) * 4 + wave] = s;
    }
}

__global__ void __launch_bounds__(256) nv_conv(const bf16_t* __restrict__ PX, const float* __restrict__ cw, const float* __restrict__ cb, bf16_t* __restrict__ XC) {
    const size_t i = (size_t)blockIdx.x * 256 + threadIdx.x;
    const int c = (int)(i & (D - 1)); const int row = (int)(i >> 10), t = row & (SEQ - 1);
    float acc = cb[c];
#pragma unroll
    for (int k = 0; k < 4; ++k) { const int tt = t - 3 + k; if (tt >= 0) acc += cw[k * D + c] * bf2f(PX[(size_t)(row - 3 + k) * D + c]); }
    XC[i] = f2bf(acc);
}

__global__ void __launch_bounds__(256) nv_scan(const __half2* __restrict__ AU, const bf16_t* __restrict__ PY, bf16_t* __restrict__ HG) {
    const int id = blockIdx.x * 256 + threadIdx.x, b = id >> 10, c = id & 1023;
    float h = 0.f;
    for (int t = 0; t < SEQ; ++t) {
        const size_t idx = (size_t)(b * SEQ + t) * D + c;
        const float2 au = __half22float2(AU[idx]);
        h = au.x * h + au.y;
        HG[idx] = f2bf(h * gelu_tanh(bf2f(PY[idx])));
    }
}

__global__ void __launch_bounds__(256) nv_kmean(const bf16_t* __restrict__ KB, float* __restrict__ KMS) {
    const int id = blockIdx.x * 256 + threadIdx.x;
    const int c = id & 1023, bb = id >> 10;
    float s = 0.f;
    for (int r = 0; r < BLK; ++r) s += bf2f(KB[(size_t)(bb * BLK + r) * D + c]);
    KMS[id] = s * (1.0f / BLK);
}

__global__ void __launch_bounds__(256) nv_attn(const bf16_t* __restrict__ QB, const bf16_t* __restrict__ KB, const bf16_t* __restrict__ VT, const float* __restrict__ KMS,
                                               const float* __restrict__ BT, bf16_t* __restrict__ AO) {
    __shared__ float qs_[4][128];
    __shared__ float sc_[4][1024];
    const int wave = threadIdx.x >> 6, lane = threadIdx.x & 63;
    const int gid = blockIdx.x * 4 + wave;
    const int h = gid & 7, row = gid >> 3, b = row >> 11, t = row & (SEQ - 1), cur = t >> 8;
    float* qs = qs_[wave]; float* sc = sc_[wave];
    qs[lane] = bf2f(QB[(size_t)row * D + h * HD + lane]); qs[lane + 64] = bf2f(QB[(size_t)row * D + h * HD + lane + 64]);
    __syncthreads();
    float g[NBLK];
#pragma unroll
    for (int n = 0; n < NBLK; ++n) { float p = 0.f;
        if (n < cur) { const float* km = KMS + ((size_t)(b * NBLK + n)) * D + h * HD; p = qs[lane] * km[lane] + qs[lane + 64] * km[lane + 64]; p = wave_sum(p); }
        g[n] = p; }
    unsigned sel = 0;
    for (int k = 0; k < 3; ++k) { int best = -1; float bv = 0.f;
#pragma unroll
        for (int n = 0; n < NBLK; ++n) if (n < cur && !((sel >> n) & 1u) && (best < 0 || g[n] > bv)) { best = n; bv = g[n]; }
        if (best >= 0) sel |= 1u << best; }
    sel |= 1u << cur;
    int nsel = 0; float mx = -1e30f;
    for (int n = 0; n <= cur; ++n) if ((sel >> n) & 1u) {
        for (int j = 0; j < 4; ++j) { const int key = n * BLK + j * 64 + lane; float s = -1e30f;
            if (key <= t) { const bf16_t* kr = KB + (size_t)(b * SEQ + key) * D + h * HD; float dsum = 0.f;
                for (int d8 = 0; d8 < 16; ++d8) { const uint4 kv = *(const uint4*)(kr + d8 * 8); const unsigned w[4] = {kv.x, kv.y, kv.z, kv.w};
#pragma unroll
                    for (int e = 0; e < 4; ++e) { dsum += qs[d8 * 8 + 2 * e] * __uint_as_float(w[e] << 16) + qs[d8 * 8 + 2 * e + 1] * __uint_as_float(w[e] & 0xffff0000u); } }
                int dist = t - key; if (dist > 128) dist = 128;
                s = dsum + BT[h * 129 + dist]; }
            sc[nsel * BLK + j * 64 + lane] = s; mx = fmaxf(mx, s); }
        ++nsel; }
#pragma unroll
    for (int o = 32; o; o >>= 1) mx = fmaxf(mx, __shfl_xor(mx, o));
    float l = 0.f;
    for (int i = lane; i < nsel * BLK; i += 64) { const float p = exp2f(sc[i] - mx); sc[i] = p; l += p; }
    l = wave_sum(l);
    __syncthreads();
    float o0 = 0.f, o1 = 0.f; int si = 0;
    for (int n = 0; n <= cur; ++n) if ((sel >> n) & 1u) {
        const bf16_t* v0 = VT + (size_t)(h * HD + lane) * M + b * SEQ + n * BLK; const bf16_t* v1 = v0 + (size_t)64 * M;
        for (int k8 = 0; k8 < 32; ++k8) { const uint4 a = *(const uint4*)(v0 + k8 * 8), c = *(const uint4*)(v1 + k8 * 8);
            const unsigned wa[4] = {a.x, a.y, a.z, a.w}, wc[4] = {c.x, c.y, c.z, c.w};
#pragma unroll
            for (int e = 0; e < 4; ++e) { const float p0 = sc[si * BLK + k8 * 8 + 2 * e], p1 = sc[si * BLK + k8 * 8 + 2 * e + 1];
                o0 += p0 * __uint_as_float(wa[e] << 16) + p1 * __uint_as_float(wa[e] & 0xffff0000u);
                o1 += p0 * __uint_as_float(wc[e] << 16) + p1 * __uint_as_float(wc[e] & 0xffff0000u); } }
        ++si; }
    const float inv = 1.0f / l;
    AO[(size_t)row * D + h * HD + lane] = f2bf(o0 * inv); AO[(size_t)row * D + h * HD + lane + 64] = f2bf(o1 * inv);
}

extern "C" void kernel_launch(void* const* d_in, const int* in_sizes, int n_in, void* d_out, int out_size, void* d_ws, size_t ws_size, hipStream_t stream) {
    if (n_in != 29 || in_sizes[0] != M * D || out_size != M * D || ws_size < WS_END) { fprintf(stderr, "kernel_launch: unexpected shapes (n_in %d, ws %zu)\n", n_in, ws_size); return; }
    const float* const* in = (const float* const*)d_in;
    unsigned char* ws = (unsigned char*)d_ws;
    float* X = (float*)d_out;
    float* RSS = (float*)(ws + WS_RSS); float* KMS = (float*)(ws + WS_KMS); float* BT = (float*)(ws + WS_BT);
    bf16_t* XB = (bf16_t*)(ws + WS_XB); bf16_t* H = (bf16_t*)(ws + WS_H);
    bf16_t* PX = (bf16_t*)(ws + WS_PX); bf16_t* PY = (bf16_t*)(ws + WS_PY); bf16_t* XC = (bf16_t*)(ws + WS_XC); bf16_t* HG = (bf16_t*)(ws + WS_HG);
    __half2* AU = (__half2*)(ws + WS_AU);
    bf16_t* QB = (bf16_t*)(ws + WS_QB); bf16_t* AO = (bf16_t*)(ws + WS_AO); bf16_t* KB = (bf16_t*)(ws + WS_KB); bf16_t* VT = (bf16_t*)(ws + WS_VT);
    const size_t FW = (size_t)D * FF;

    nv_prep<<<M / 4, 256, 0, stream>>>(in[0], XB, RSS);
    nv_bias_table<<<(NH * 129 + 255) / 256, 256, 0, stream>>>(in[28], BT);
    const float* xsrc = in[0];
    for (int l = 0; l < 2; ++l) {
        nv_gemm<EpSwiglu><<<dim3(FF / 64, M / 64, 1), 256, 0, stream>>>(XB, D, 0, in[3] + l * FW, in[4] + l * FW, FF, 0, in[1] + l * D, D, EpSwiglu{RSS, H});
        nv_rowgemm_norm<<<M / 8, 256, 0, stream>>>(H, FF, in[5] + l * FW, nullptr, in[2] + l * D, 0.5f, xsrc, X, XB, RSS);
        xsrc = X;
        if (l == 0) {
            nv_gemm<EpInproj><<<dim3(2 * D / 64, M / 64, 1), 256, 0, stream>>>(XB, D, 0, in[13], nullptr, 2 * D, 0, in[11], D, EpInproj{RSS, in[14], PX, PY});
            nv_conv<<<M * D / 256, 256, 0, stream>>>(PX, in[15], in[16], XC);
            nv_gemm<EpGates><<<dim3(256 / 64, M / 64, 4), 256, 0, stream>>>(XC, D, 256, in[17], in[19], 256, 65536, nullptr, 256, EpGates{in[18], in[20], in[21], XC, AU});
            nv_scan<<<BATCH * D / 256, 256, 0, stream>>>(AU, PY, HG);
            nv_rowgemm_norm<<<M / 8, 256, 0, stream>>>(HG, D, in[22], in[23], in[12], 1.0f, X, X, XB, RSS);
        } else {
            nv_gemm<EpQ><<<dim3(D / 64, M / 64, 1), 256, 0, stream>>>(XB, D, 0, in[26], nullptr, D, 0, in[11] + D, D, EpQ{RSS, QB});
            nv_attn<<<M * NH / 4, 256, 0, stream>>>(QB, KB, VT, KMS, BT, AO);
            nv_rowgemm_norm<<<M / 8, 256, 0, stream>>>(AO, D, in[27], nullptr, in[12] + D, 1.0f, X, X, XB, RSS);
        }
        nv_gemm<EpSwiglu><<<dim3(FF / 64, M / 64, 1), 256, 0, stream>>>(XB, D, 0, in[8] + l * FW, in[9] + l * FW, FF, 0, in[6] + l * D, D, EpSwiglu{RSS, H});
        nv_rowgemm_norm<<<M / 8, 256, 0, stream>>>(H, FF, in[10] + l * FW, nullptr, in[7] + l * D, 0.5f, X, X, XB, RSS);
        if (l == 0) {
            nv_gemm<EpKV><<<dim3(2 * D / 64, M / 64, 1), 256, 0, stream>>>(XB, D, 0, in[25], nullptr, 2 * D, 0, in[24], D, EpKV{RSS, KB, VT});
            nv_kmean<<<BATCH * NBLK * D / 256, 256, 0, stream>>>(KB, KMS);
        }
    }
}
```
